# Optimizing an MI355X kernel written in HIP

```python
import math
import jax, jax.numpy as jnp
from jax import lax
import numpy as np

D_MODEL = 1024
BATCH = 8
SEQ = 2048
DEPTH = 1

CHUNK = 64
POOL_WINDOWS = (2, 4, 8, 16)
POOL_GROUPS = len(POOL_WINDOWS)
POOL_WIDTH = D_MODEL // 2
POOL_GROUP_DIM = POOL_WIDTH // POOL_GROUPS
RET_HEADS = 4
RET_WIDTH = D_MODEL // 2
RET_HEAD_DIM = RET_WIDTH // RET_HEADS
N_BRANCHES = 2
IN_WIDTH = POOL_WIDTH + 4 * RET_WIDTH + N_BRANCHES * D_MODEL
D_FF = 4 * D_MODEL
N_MOD = 6
ROPE_BASE = 10000.0
EPS = 1e-6

kernel_name = "chunk_causal_pool_retention_hybrid_block"


def _rmsnorm(x, g):
    xf = x.astype(jnp.float32)
    y = xf * lax.rsqrt(jnp.mean(xf * xf, axis=-1, keepdims=True) + EPS)
    return (y * g.astype(jnp.float32)).astype(x.dtype)


def _rope(x, positions):
    half = x.shape[-1] // 2
    inv_freq = ROPE_BASE ** (-jnp.arange(half, dtype=jnp.float32) / half)
    ang = positions.astype(jnp.float32)[..., None] * inv_freq
    cos = jnp.cos(ang)[:, :, None, :].astype(x.dtype)
    sin = jnp.sin(ang)[:, :, None, :].astype(x.dtype)
    x1, x2 = x[..., :half], x[..., half:]
    return jnp.concatenate([x1 * cos - x2 * sin, x2 * cos + x1 * sin], axis=-1)


def _pool_branch(u, w_group, scale):
    B, S, _ = u.shape
    uf = u.astype(jnp.float32)
    cs = jnp.cumsum(uf, axis=1)
    t = jnp.arange(1, S + 1, dtype=jnp.float32)[None, :, None]
    outs = []
    for gi, w in enumerate(POOL_WINDOWS):
        sl = slice(gi * POOL_GROUP_DIM, (gi + 1) * POOL_GROUP_DIM)
        cg = cs[..., sl]
        lag = jnp.pad(cg[:, :S - w], ((0, 0), (w, 0), (0, 0)))
        mean = (cg - lag) / jnp.minimum(t, float(w))
        outs.append(mean - uf[..., sl])
    pooled = jnp.stack(outs, axis=2).astype(u.dtype)
    mixed = jnp.einsum('bsgc,gcd->bsgd', pooled, w_group).reshape(B, S, POOL_WIDTH)
    return mixed * scale


def _retention_branch(q, k, v, g, positions):
    B, S, _ = q.shape
    N = S // CHUNK
    H, d = RET_HEADS, RET_HEAD_DIM
    q = _rope(q.reshape(B, S, H, d), positions) * (d ** -0.5)
    k = _rope(k.reshape(B, S, H, d), positions)
    v = v.reshape(B, S, H, d)
    log_gamma = jnp.log(1.0 - 2.0 ** (-5.0 - jnp.arange(H, dtype=jnp.float32)))
    idx = jnp.arange(CHUNK, dtype=jnp.float32)
    dist = jnp.abs(idx[:, None] - idx[None, :])
    d_intra = jnp.exp(log_gamma[:, None, None] * dist).astype(q.dtype)
    k_decay = jnp.exp(log_gamma[None, :] * (CHUNK - 1 - idx)[:, None]).astype(q.dtype)
    q_decay = jnp.exp(log_gamma[None, :] * (idx + 1)[:, None]).astype(q.dtype)
    chunk_decay = jnp.exp(log_gamma * CHUNK).astype(q.dtype)

    qc = q.reshape(B, N, CHUNK, H, d)
    kc = k.reshape(B, N, CHUNK, H, d)
    vc = v.reshape(B, N, CHUNK, H, d)

    scores = jnp.einsum('bnihd,bnjhd->bnhij', qc, kc) * d_intra
    o_intra = jnp.einsum('bnhij,bnjhe->bnihe', scores, vc)

    kv = jnp.einsum('bnjhd,bnjhe->nbhde', kc * k_decay[:, :, None], vc)

    def step(state, kv_n):
        return state * chunk_decay[None, :, None, None] + kv_n, state

    _, states = lax.scan(step, jnp.zeros_like(kv[0]), kv)
    o_cross = jnp.einsum('bnihd,nbhde->bnihe', qc * q_decay[:, :, None], states)

    o = (o_intra + o_cross).reshape(B, S, H, d).astype(jnp.float32)
    mu = jnp.mean(o, axis=-1, keepdims=True)
    var = jnp.mean(jnp.square(o - mu), axis=-1, keepdims=True)
    o_norm = ((o - mu) * lax.rsqrt(var + EPS)).reshape(B, S, RET_WIDTH).astype(g.dtype)
    return jax.nn.silu(g) * o_norm


def _mixer(h, positions, w_in, b_branch_gate, pool_w, pool_scale,
           w_branch_pool, w_branch_ret, w_out):
    B, S, _ = h.shape
    proj = h @ w_in
    cuts = [POOL_WIDTH + i * RET_WIDTH for i in range(5)]
    u_pool, q, k, v, g_ret, gate_logits = jnp.split(proj, cuts, axis=-1)
    y_pool = _pool_branch(u_pool, pool_w, pool_scale) @ w_branch_pool
    y_ret = _retention_branch(q, k, v, g_ret, positions) @ w_branch_ret
    gates = jax.nn.sigmoid(gate_logits + b_branch_gate).reshape(B, S, N_BRANCHES, D_MODEL)
    merged = gates[:, :, 0] * y_pool + gates[:, :, 1] * y_ret
    return merged @ w_out


def setup_inputs(seed: int = 0) -> dict:
    key = jax.random.key(seed)
    ks = jax.random.split(key, 20)
    f32 = jnp.float32

    def nrm(k, shape, scale):
        return jax.random.normal(k, shape, f32) * scale

    def gain(k, shape):
        return 1.0 + 0.05 * jax.random.normal(k, shape, f32)

    x = jax.random.normal(ks[0], (BATCH, SEQ, D_MODEL), f32)
    c = jax.random.normal(ks[1], (BATCH, D_MODEL), f32)
    offsets = jax.random.randint(ks[2], (BATCH, 1), 0, 4096, dtype=jnp.int32)
    positions = offsets + jnp.arange(SEQ, dtype=jnp.int32)[None, :]
    return {
        "x": x,
        "c": c,
        "positions": positions,
        "ada_w": nrm(ks[3], (DEPTH, D_MODEL, N_MOD * D_MODEL), 0.5 * D_MODEL ** -0.5),
        "ada_b": nrm(ks[4], (DEPTH, N_MOD * D_MODEL), 0.02),
        "mix_pre_g": gain(ks[5], (DEPTH, D_MODEL)),
        "mix_post_g": gain(ks[6], (DEPTH, D_MODEL)),
        "ffn_pre_g": gain(ks[7], (DEPTH, D_MODEL)),
        "ffn_post_g": gain(ks[8], (DEPTH, D_MODEL)),
        "w_in": nrm(ks[9], (DEPTH, D_MODEL, IN_WIDTH), D_MODEL ** -0.5),
        "b_branch_gate": nrm(ks[10], (DEPTH, N_BRANCHES * D_MODEL), 0.02),
        "pool_w": nrm(ks[11], (DEPTH, POOL_GROUPS, POOL_GROUP_DIM, POOL_GROUP_DIM), POOL_GROUP_DIM ** -0.5),
        "pool_scale": 1.0 + 0.1 * jax.random.normal(ks[12], (DEPTH, POOL_WIDTH), f32),
        "w_branch_pool": nrm(ks[13], (DEPTH, POOL_WIDTH, D_MODEL), POOL_WIDTH ** -0.5),
        "w_branch_ret": nrm(ks[14], (DEPTH, RET_WIDTH, D_MODEL), RET_WIDTH ** -0.5),
        "w_out": nrm(ks[15], (DEPTH, D_MODEL, D_MODEL), D_MODEL ** -0.5),
        "w_ff1": nrm(ks[16], (DEPTH, D_MODEL, D_FF), D_MODEL ** -0.5),
        "w_ff2": nrm(ks[17], (DEPTH, D_FF, D_MODEL), D_FF ** -0.5),
    }


def reference(x, c, positions, ada_w, ada_b, mix_pre_g, mix_post_g, ffn_pre_g, ffn_post_g,
              w_in, b_branch_gate, pool_w, pool_scale, w_branch_pool, w_branch_ret, w_out,
              w_ff1, w_ff2):
    for l in range(DEPTH):
        mod = jax.nn.silu(c) @ ada_w[l] + ada_b[l]
        sh_m, sc_m, gt_m, sh_f, sc_f, gt_f = [m[:, None, :] for m in jnp.split(mod, N_MOD, axis=-1)]

        h = _rmsnorm(x, mix_pre_g[l]) * (1.0 + sc_m) + sh_m
        y = _mixer(h, positions, w_in[l], b_branch_gate[l], pool_w[l], pool_scale[l],
                   w_branch_pool[l], w_branch_ret[l], w_out[l])
        x = x + gt_m * _rmsnorm(y, mix_post_g[l])

        h = _rmsnorm(x, ffn_pre_g[l]) * (1.0 + sc_f) + sh_f
        y = jnp.square(jax.nn.relu(h @ w_ff1[l])) @ w_ff2[l]
        x = x + gt_f * _rmsnorm(y, ffn_post_g[l])
    return x
```

```cpp
#include <hip/hip_runtime.h>
#include <cstdio>
#include <cstdint>
namespace pg8 {
#define PG8_LAS __attribute__((address_space(3)))
typedef unsigned short bf16_t;
typedef short bf16x8 __attribute__((ext_vector_type(8)));
typedef float f32x4 __attribute__((ext_vector_type(4)));
typedef unsigned u32x4 __attribute__((ext_vector_type(4)));
constexpr int BM = 256, BK = 64, HALF = 128, HTB = HALF * BK * 2  , STAGE_BYTES = 8 * HTB, NXCD = 8, WGM = 8;

__host__ __device__ __forceinline__ int lds_byte(int r, int c) { const int st = (r >> 4) * 2 + (c >> 5), rr = r & 15, cc = c & 31, ob = rr * 64 + cc * 2; return st * 1024 + (ob ^ (((ob >> 9) & 1) << 5)); }
__host__ __device__ __forceinline__ void stage_rc(int b, int& R, int& C) { const int st = b / 1024, sb = b % 1024, swz = sb ^ (((sb >> 9) & 1) << 5); R = (st >> 1) * 16 + swz / 64; C = (st & 1) * 32 + (swz % 64) / 2; }
__host__ __device__ __forceinline__ int perm32(int rho) { const int n = rho >> 4, i = rho & 15; return 8 * (i >> 2) + 4 * n + (i & 3); }

struct Unit { int pm, pn; };
struct Gemm { const bf16_t* A; const bf16_t* A2; const bf16_t* Bt; int M, N, K, pn_split; };

struct StaticOrder {
    int nM, nN, nwg, G, c;
    __host__ __device__ void init(int M, int N, int G_, int c_) { nM = M / BM; nN = N / BM; nwg = nM * nN; G = G_; c = c_; }
    __host__ __device__ bool next(int i, Unit& u) const {
        const long L = (long)i * G + c; if (L >= nwg) return false;
        int wgid = (int)L; { const int q = nwg / NXCD, r = nwg % NXCD, xcd = wgid % NXCD, off = wgid / NXCD; wgid = (xcd < r ? xcd * (q + 1) : r * (q + 1) + (xcd - r) * q) + off; }
        const int nig = WGM * nN, gid = wgid / nig, fm = gid * WGM, gsz = (nM - fm) < WGM ? (nM - fm) : WGM;
        u.pm = fm + ((wgid % nig) % gsz); u.pn = (wgid % nig) / gsz; return true;
    }
    __device__ __forceinline__ void a_ready(const Unit&) const {}
    __device__ __forceinline__ void done(const Unit&) const {}
};

__device__ __forceinline__ unsigned cvt_pk_bf16(float lo, float hi) { unsigned r; asm volatile("v_cvt_pk_bf16_f32 %0, %1, %2" : "=v"(r) : "v"(lo), "v"(hi)); return r; }
typedef float f32x2 __attribute__((ext_vector_type(2)));
__device__ __forceinline__ float bf_lo(unsigned u) { return __uint_as_float(u << 16); }
__device__ __forceinline__ float bf_hi(unsigned u) { return __uint_as_float(u & 0xffff0000u); }
__device__ __forceinline__ float fast_sigmoid(float v) { return __builtin_amdgcn_rcpf(1.0f + __expf(-v)); }

struct MergeOrder {
    StaticOrder inner;
    __device__ bool next(int i, Unit& u) const { if (!inner.next(i >> 1, u)) return false; u.pn += (i & 1) * 4; return true; }
    __device__ __forceinline__ void a_ready(const Unit&) const {}
    __device__ __forceinline__ void done(const Unit&) const {}
};

enum { EP_PLAIN = 0, EP_PROJ = 1, EP_RELU2 = 2, EP_MERGE = 3 };
template <int MODE> struct Epi {
    static constexpr bool PERM = true, AFTER_DRAIN = false;
    bf16_t* O; int ldc; const float* bias; const bf16_t* gates;
    __device__ __forceinline__ void operator()(const f32x4 (&acc)[2][2][4][2], const Unit& u, int wr, int wc, int fr, int fq) const {
        const int row0 = u.pm * BM + wr * 64 + fr;
        int pn = u.pn, mode = 0, second = 0;
        if (MODE == EP_PROJ) mode = pn < 8 ? 0 : (pn < 10 ? 1 : 2);
        if (MODE == EP_MERGE) { second = pn >= 4 ? 1 : 0; pn &= 3; }
        const int col0 = pn * BM + wc * 32 + 8 * fq;
        f32x4 bv[2][2];
#pragma unroll
        for (int bj = 0; bj < 2; ++bj)
#pragma unroll
            for (int n = 0; n < 2; ++n) bv[bj][n] = (MODE == EP_PROJ && mode == 2) ? *(const f32x4*)(bias + (col0 - 2560) + bj * HALF + 4 * n) : (f32x4){0.f, 0.f, 0.f, 0.f};
#pragma unroll
        for (int ai = 0; ai < 2; ++ai)
#pragma unroll
            for (int m = 0; m < 4; ++m) { const int row = row0 + ai * HALF + m * 16; bf16_t* rowp = O + (size_t)row * ldc + col0;
#pragma unroll
                for (int bj = 0; bj < 2; ++bj) { f32x4 v0 = acc[ai][bj][m][0], v1 = acc[ai][bj][m][1];
                    if (MODE == EP_PROJ) {
                        if (mode == 1) {
#pragma unroll
                            for (int e = 0; e < 4; ++e) { v0[e] = v0[e] * fast_sigmoid(v0[e]); v1[e] = v1[e] * fast_sigmoid(v1[e]); }
                        } else if (mode == 2) { v0 = v0 + bv[bj][0]; v1 = v1 + bv[bj][1];
#pragma unroll
                            for (int e = 0; e < 4; ++e) { v0[e] = fast_sigmoid(v0[e]); v1[e] = fast_sigmoid(v1[e]); }
                        }
                    }
                    if (MODE == EP_RELU2) {
#pragma unroll
                        for (int e = 0; e < 4; ++e) { const float a = fmaxf(v0[e], 0.f), b = fmaxf(v1[e], 0.f); v0[e] = a * a; v1[e] = b * b; }
                    }
                    if (MODE == EP_MERGE) {
                        const u32x4 gw = *(const u32x4*)(gates + (size_t)row * 4608 + 2560 + second * 1024 + col0 + bj * HALF);
                        v0[0] *= bf_lo(gw.x); v0[1] *= bf_hi(gw.x); v0[2] *= bf_lo(gw.y); v0[3] *= bf_hi(gw.y);
                        v1[0] *= bf_lo(gw.z); v1[1] *= bf_hi(gw.z); v1[2] *= bf_lo(gw.w); v1[3] *= bf_hi(gw.w);
                        if (second) { const u32x4 pw = *(const u32x4*)(rowp + bj * HALF);
                            v0[0] += bf_lo(pw.x); v0[1] += bf_hi(pw.x); v0[2] += bf_lo(pw.y); v0[3] += bf_hi(pw.y);
                            v1[0] += bf_lo(pw.z); v1[1] += bf_hi(pw.z); v1[2] += bf_lo(pw.w); v1[3] += bf_hi(pw.w); }
                    }
                    u32x4 w; w.x = cvt_pk_bf16(v0[0], v0[1]); w.y = cvt_pk_bf16(v0[2], v0[3]); w.z = cvt_pk_bf16(v1[0], v1[1]); w.w = cvt_pk_bf16(v1[2], v1[3]);
                    *(u32x4*)(rowp + bj * HALF) = w; } }
    }
};

template <class Epi, class Sched, bool ALIGN_EPI = false, bool SP2 = false>
__device__ __forceinline__ void gemm_phase(PG8_LAS unsigned char* lds, const Gemm g, const Sched& S, const Epi& E) {
    const int tid = threadIdx.x, wid = __builtin_amdgcn_readfirstlane(tid >> 6), lane = tid & 63, wr = wid >> 2, wc = wid & 3, fr = lane & 15, fq = lane >> 4;
    const int K = g.K, nt = K / BK;
    unsigned voffA[2], voffB[2];
#pragma unroll
    for (int i = 0; i < 2; ++i) { int R, C; stage_rc(tid * 16 + i * 8192, R, C); const int Rb = Epi::PERM ? ((R & ~31) + perm32(R & 31)) : R;
        voffA[i] = (unsigned)(R * K + C) * 2u; voffB[i] = (unsigned)(Rb * K + C) * 2u; }
    const size_t kstep = (size_t)(BK * 2);
    const size_t hstep = (size_t)HALF * K * 2;
    const size_t tstep = 2 * hstep;
    const unsigned ldsw = (unsigned)wid * 1024u;
    const int aoff = lds_byte(wr * 64 + fr, fq * 8), boff = lds_byte(wc * 32 + fr, fq * 8);
#define PG8_SA(b, h) (((b) * 2 + (h)) * HTB)
#define PG8_SB(b, h) ((4 + (b) * 2 + (h)) * HTB)
#define PG8_STAGE(bufoff, gbase, voff) do { _Pragma("unroll") for (int _i = 0; _i < 2; ++_i) \
        __builtin_amdgcn_global_load_lds((const unsigned*)((const char*)(gbase) + (voff)[_i]), (PG8_LAS unsigned*)(lds + (bufoff) + ldsw + _i * 8192), 16, 0, 0); } while (0)
#define PG8_LDA(dst, b, h) do { _Pragma("unroll") for (int m = 0; m < 4; ++m) _Pragma("unroll") for (int k = 0; k < 2; ++k) dst[m][k] = *(const PG8_LAS bf16x8*)(lds + PG8_SA(b, h) + aoff + m * 2048 + k * 1024); } while (0)
#define PG8_LDB(dst, b, h) do { _Pragma("unroll") for (int n = 0; n < 2; ++n) _Pragma("unroll") for (int k = 0; k < 2; ++k) dst[n][k] = *(const PG8_LAS bf16x8*)(lds + PG8_SB(b, h) + boff + n * 2048 + k * 1024); } while (0)
#define PG8_MMA(ai, bj, At, Bt) do { __builtin_amdgcn_s_setprio(1); _Pragma("unroll") for (int m = 0; m < 4; ++m) _Pragma("unroll") for (int n = 0; n < 2; ++n) _Pragma("unroll") for (int k = 0; k < 2; ++k) \
        acc[ai][bj][m][n] = __builtin_amdgcn_mfma_f32_16x16x32_bf16(Bt[n][k], At[m][k], acc[ai][bj][m][n], 0, 0, 0); __builtin_amdgcn_s_setprio(0); } while (0)
#define PG8_WAIT_V(n) asm volatile("s_waitcnt vmcnt(" #n ")" ::: "memory")
#define PG8_WAIT_L(n) asm volatile("s_waitcnt lgkmcnt(" #n ")" ::: "memory")
#define PG8_BAR __builtin_amdgcn_s_barrier()
#define PG8_SCHED __builtin_amdgcn_sched_barrier(0)
    Unit cur, nxt; int ui = 0;
    if (!S.next(0, cur)) return;
    f32x4 acc[2][2][4][2];
#pragma unroll
    for (int a = 0; a < 2; ++a)
#pragma unroll
        for (int b = 0; b < 2; ++b)
#pragma unroll
            for (int m = 0; m < 4; ++m)
#pragma unroll
                for (int n = 0; n < 2; ++n) acc[a][b][m][n] = (f32x4){0.f, 0.f, 0.f, 0.f};
    bf16x8 At[4][2], B0[2][2], B1[2][2];
    const char* cA = (const char*)(cur.pn >= g.pn_split ? g.A2 : g.A) + (size_t)cur.pm * tstep; const char* cB = (const char*)g.Bt + (size_t)cur.pn * tstep;
    S.a_ready(cur);
    if constexpr (SP2) {
        PG8_STAGE(PG8_SB(0, 0), cB, voffB); PG8_STAGE(PG8_SB(0, 1), cB + hstep, voffB); PG8_STAGE(PG8_SA(0, 0), cA, voffA); PG8_STAGE(PG8_SA(0, 1), cA + hstep, voffA);
        if (wr == 1) PG8_BAR;
        PG8_WAIT_V(2); PG8_BAR;
        PG8_STAGE(PG8_SB(1, 0), cB + kstep, voffB); PG8_STAGE(PG8_SA(1, 0), cA + kstep, voffA); PG8_STAGE(PG8_SB(1, 1), cB + hstep + kstep, voffB);
        PG8_WAIT_V(6); PG8_BAR;
    } else {
        PG8_STAGE(PG8_SB(0, 0), cB, voffB); PG8_STAGE(PG8_SA(0, 0), cA, voffA); PG8_STAGE(PG8_SB(0, 1), cB + hstep, voffB); PG8_STAGE(PG8_SA(0, 1), cA + hstep, voffA);
        if (wr == 1) PG8_BAR;
        PG8_WAIT_V(4); PG8_BAR;
        PG8_STAGE(PG8_SB(1, 0), cB + kstep, voffB); PG8_STAGE(PG8_SA(1, 0), cA + kstep, voffA); PG8_STAGE(PG8_SB(1, 1), cB + hstep + kstep, voffB);
        PG8_WAIT_V(6); PG8_BAR;
    }
    for (;;) {
        const bool has_next = S.next(ui + 1, nxt);
        const char* nA = has_next ? (const char*)(nxt.pn >= g.pn_split ? g.A2 : g.A) + (size_t)nxt.pm * tstep : cA; const char* nB = has_next ? (const char*)g.Bt + (size_t)nxt.pn * tstep : cB;
        for (int t = 0; t < nt; t += 2) {
            const bool last = (t == nt - 2);
            const char* a1 = cA + (size_t)(t + 1) * kstep;
            const char* a2 = last ? nA : cA + (size_t)(t + 2) * kstep; const char* b2 = last ? nB : cB + (size_t)(t + 2) * kstep;
            const char* a3 = a2 + kstep; const char* b3 = b2 + kstep;
            if (last && has_next) S.a_ready(nxt);
            if constexpr (SP2) {
            PG8_LDB(B0, 0, 0); PG8_LDB(B1, 0, 1); PG8_SCHED; PG8_LDA(At, 0, 0); PG8_STAGE(PG8_SA(1, 1), a1 + hstep, voffA);
            PG8_WAIT_V(8); PG8_WAIT_L(0); PG8_BAR; PG8_MMA(0, 0, At, B0); PG8_MMA(0, 1, At, B1); PG8_BAR; PG8_SCHED;
            PG8_LDA(At, 0, 1); PG8_STAGE(PG8_SB(0, 0), b2, voffB); PG8_STAGE(PG8_SB(0, 1), b2 + hstep, voffB); PG8_STAGE(PG8_SA(0, 0), a2, voffA);
            PG8_WAIT_V(8); PG8_WAIT_L(0); PG8_BAR; PG8_MMA(1, 0, At, B0); PG8_MMA(1, 1, At, B1); PG8_BAR; PG8_SCHED;
            PG8_LDB(B0, 1, 0); PG8_LDB(B1, 1, 1); PG8_SCHED; PG8_LDA(At, 1, 0); PG8_STAGE(PG8_SA(0, 1), a2 + hstep, voffA);
            PG8_WAIT_V(8); PG8_WAIT_L(0); PG8_BAR; PG8_MMA(0, 0, At, B0); PG8_MMA(0, 1, At, B1); PG8_BAR; PG8_SCHED;
            PG8_LDA(At, 1, 1); PG8_STAGE(PG8_SB(1, 0), b3, voffB); PG8_STAGE(PG8_SB(1, 1), b3 + hstep, voffB); PG8_STAGE(PG8_SA(1, 0), a3, voffA);
            PG8_WAIT_V(8); PG8_WAIT_L(0); PG8_BAR; PG8_MMA(1, 0, At, B0); PG8_MMA(1, 1, At, B1); PG8_BAR; PG8_SCHED;
            } else {
            PG8_LDB(B0, 0, 0); PG8_SCHED; PG8_LDA(At, 0, 0); PG8_STAGE(PG8_SA(1, 1), a1 + hstep, voffA);
            PG8_WAIT_L(8); PG8_BAR; PG8_WAIT_L(0); PG8_MMA(0, 0, At, B0); PG8_BAR; PG8_SCHED;
            PG8_LDB(B1, 0, 1); PG8_STAGE(PG8_SB(0, 0), b2, voffB);
            PG8_BAR; PG8_WAIT_L(0); PG8_MMA(0, 1, At, B1); PG8_BAR;
            PG8_LDA(At, 0, 1); PG8_STAGE(PG8_SA(0, 0), a2, voffA);
            PG8_BAR; PG8_WAIT_L(0); PG8_MMA(1, 0, At, B0); PG8_BAR; PG8_SCHED;
            PG8_STAGE(PG8_SB(0, 1), b2 + hstep, voffB);
            PG8_WAIT_V(6); PG8_BAR; PG8_MMA(1, 1, At, B1); PG8_BAR;
            PG8_LDB(B0, 1, 0); PG8_SCHED; PG8_LDA(At, 1, 0); PG8_STAGE(PG8_SA(0, 1), a2 + hstep, voffA);
            PG8_WAIT_L(8); PG8_BAR; PG8_WAIT_L(0); PG8_MMA(0, 0, At, B0); PG8_BAR; PG8_SCHED;
            PG8_LDB(B1, 1, 1); PG8_STAGE(PG8_SB(1, 0), b3, voffB);
            PG8_BAR; PG8_WAIT_L(0); PG8_MMA(0, 1, At, B1); PG8_BAR;
            PG8_LDA(At, 1, 1); PG8_STAGE(PG8_SA(1, 0), a3, voffA);
            PG8_BAR; PG8_WAIT_L(0); PG8_MMA(1, 0, At, B0); PG8_BAR; PG8_SCHED;
            PG8_STAGE(PG8_SB(1, 1), b3 + hstep, voffB);
            PG8_WAIT_V(6); PG8_BAR; PG8_MMA(1, 1, At, B1); PG8_BAR;
            }
        }
        if constexpr (ALIGN_EPI) { if (wr == 0) PG8_BAR; }
        if constexpr (!Epi::AFTER_DRAIN) { E(acc, cur, wr, wc, fr, fq); S.done(cur); }
        if (!has_next) break;
#pragma unroll
        for (int a = 0; a < 2; ++a)
#pragma unroll
            for (int b = 0; b < 2; ++b)
#pragma unroll
                for (int m = 0; m < 4; ++m)
#pragma unroll
                    for (int n = 0; n < 2; ++n) acc[a][b][m][n] = (f32x4){0.f, 0.f, 0.f, 0.f};
        cur = nxt; cA = nA; cB = nB; ++ui;
        if constexpr (ALIGN_EPI) { if (wr == 1) PG8_BAR; }
    }
    PG8_WAIT_V(0);
    if constexpr (!ALIGN_EPI) { if (wr == 0) PG8_BAR; }
    PG8_BAR;
    if constexpr (Epi::AFTER_DRAIN) { E.fused(acc, cur, wr, wc, fr, fq, lds, wid, lane); S.done(cur); }
#undef PG8_SA
#undef PG8_SB
#undef PG8_STAGE
#undef PG8_LDA
#undef PG8_LDB
#undef PG8_MMA
#undef PG8_WAIT_V
#undef PG8_WAIT_L
#undef PG8_BAR
#undef PG8_SCHED
}
}
#define GAS __attribute__((address_space(1)))
#define LAS __attribute__((address_space(3)))
typedef unsigned short bf16;
typedef unsigned v4u __attribute__((ext_vector_type(4)));
typedef float f32x4 __attribute__((ext_vector_type(4)));
typedef short bf16x8 __attribute__((ext_vector_type(8)));
typedef GAS unsigned gu32;
typedef GAS unsigned long long gu64;
#define RLX_AGENT __ATOMIC_RELAXED, __HIP_MEMORY_SCOPE_AGENT
#define LDS_WAIT() asm volatile("s_waitcnt lgkmcnt(0)" ::: "memory")
#define VM_WAIT() asm volatile("s_waitcnt vmcnt(0)" ::: "memory")
__device__ __forceinline__ unsigned f2bf(float f) { unsigned u = __builtin_bit_cast(unsigned, f); return (u + 0x7fffu + ((u >> 16) & 1u)) >> 16; }
__device__ __forceinline__ unsigned pk2(float lo, float hi) { return f2bf(lo) | (f2bf(hi) << 16); }

#define XB_TMO      128
#define XB_XCNT(j)  (256  + 64 * (j))
#define XB_XSUB(j)  (1280 + 64 * (j))
#define XB_XGEN(j)  (2304 + 64 * (j))
#define XB_TOP      3328
#define XB_TOPGEN   3392
#define XCD_BAR_WORDS 3456
#define XB_SPIN_CAP (1u << 18)

__device__ __forceinline__ unsigned xb_ld(unsigned* p)              { return __hip_atomic_load(p, __ATOMIC_RELAXED, __HIP_MEMORY_SCOPE_AGENT); }
__device__ __forceinline__ unsigned xb_add(unsigned* p, unsigned v) { return __hip_atomic_fetch_add(p, v, __ATOMIC_RELAXED, __HIP_MEMORY_SCOPE_AGENT); }
__device__ __forceinline__ unsigned xb_xcc_id() { return (unsigned)__builtin_amdgcn_s_getreg((3 << 11) | 20) & 0xFu; }
#define XB_SPIN(cond, bar) do { unsigned _sp = 0; while (cond) { __builtin_amdgcn_s_sleep(1); \
    if ((++_sp & 255u) == 0u) { if (xb_ld(&(bar)[XB_TMO])) break; if (_sp > XB_SPIN_CAP) { atomicAdd(&(bar)[XB_TMO], 1u); break; } } } } while (0)

struct XcdBarrier {
    unsigned* bar; unsigned x;
    volatile LAS unsigned* st;
};

__device__ __forceinline__ XcdBarrier xcd_barrier_post(unsigned* bar, volatile LAS unsigned* st) {
    XcdBarrier b; b.bar = bar; b.x = xb_xcc_id(); b.st = st;
    if (threadIdx.x == 0) (void)xb_add(&bar[XB_XCNT(b.x)], 1u);
    return b;
}
__device__ __forceinline__ void xcd_barrier_complete(unsigned* bar, unsigned x, unsigned& nloc, unsigned& nx) {
    const unsigned G = gridDim.x * gridDim.y * gridDim.z;
    unsigned sum, cnt, mine, sp = 0u;
    for (;;) {
        sum = 0u; cnt = 0u; mine = 0u;
#pragma unroll
        for (unsigned j = 0; j < 16; ++j) { const unsigned c = xb_ld(&bar[XB_XCNT(j)]); sum += c; cnt += (c > 0u) ? 1u : 0u; mine = (j == x) ? c : mine; }
        if (sum == G) break;
        __builtin_amdgcn_s_sleep(1);
        if ((++sp & 255u) == 0u) { if (xb_ld(&bar[XB_TMO])) break; if (sp > XB_SPIN_CAP) { atomicAdd(&bar[XB_TMO], 1u); break; } }
    }
    nloc = mine > 0u ? mine : 1u; nx = cnt > 0u ? cnt : 1u;
}

__device__ __forceinline__ void xcd_barrier(const XcdBarrier& b) {
    asm volatile("s_waitcnt vmcnt(0)" ::: "memory");
    __syncthreads();
    if (threadIdx.x == 0) {
        unsigned* bar = b.bar;
        __builtin_amdgcn_s_waitcnt(0);
        unsigned nloc = b.st[0], nx = b.st[1];
        if (nloc == 0u) { xcd_barrier_complete(bar, b.x, nloc, nx); b.st[0] = nloc; b.st[1] = nx; }
        const unsigned old = xb_add(&bar[XB_XSUB(b.x)], 1u);
        const unsigned gen = old / nloc;
        if (old + 1u == (gen + 1u) * nloc) {
            __builtin_amdgcn_fence(__ATOMIC_RELEASE, "agent");
            asm volatile("s_waitcnt vmcnt(0)" ::: "memory");
            const unsigned og = xb_add(&bar[XB_TOP], 1u);
            const unsigned tg = og / nx;
            if (og + 1u == (tg + 1u) * nx) xb_add(&bar[XB_TOPGEN], 1u);
            else XB_SPIN(xb_ld(&bar[XB_TOPGEN]) == tg, bar);
            __builtin_amdgcn_fence(__ATOMIC_ACQUIRE, "agent");
            xb_add(&bar[XB_XGEN(b.x)], 1u);
            asm volatile("s_waitcnt vmcnt(0)" ::: "memory");
        } else {
            XB_SPIN(xb_ld(&bar[XB_XGEN(b.x)]) == gen, bar);
            __builtin_amdgcn_fence(__ATOMIC_ACQUIRE, "agent");
            asm volatile("s_waitcnt vmcnt(0)" ::: "memory");
        }
    }
    __syncthreads();
}

constexpr int NWAVES = 8;
constexpr int BATCH = 8, SEQ = 2048, D = 1024, M = BATCH * SEQ, INW = 4608, FF = 4096, NMOD = 6 * D;
constexpr int C_U = 0, C_Q = 512, C_K = 1024, C_V = 1536, C_G = 2048, C_GATE = 2560;
constexpr float EPS = 1e-6f;
constexpr size_t MiB = 1u << 20;
constexpr size_t WS_CTL = 0, CTL_ZERO_BYTES = 64 * 1024;
constexpr size_t WS_MOD = 1 * MiB;
constexpr size_t WS_WIN = 2 * MiB;
constexpr size_t WS_WPR = 11 * MiB;
constexpr size_t WS_WOUT = 13 * MiB;
constexpr size_t WS_W1 = 15 * MiB;
constexpr size_t WS_W2 = 23 * MiB;
constexpr size_t WS_XN = 32 * MiB;
constexpr size_t WS_PR = 64 * MiB;
constexpr size_t WS_PROJ = 96 * MiB;
constexpr size_t WS_END = 240 * MiB;
constexpr int CW_BAR = 1024;
constexpr int LDS_BYTES = 147456, MISC_OFF = 131072 + 320;

__device__ __forceinline__ float wave_sum(float v) {
#pragma unroll
    for (int o = 1; o < 64; o <<= 1) v += __shfl_xor(v, o);
    return v;
}
__device__ __forceinline__ float bf_lo(unsigned u) { return __uint_as_float(u << 16); }
__device__ __forceinline__ float bf_hi(unsigned u) { return __uint_as_float(u & 0xffff0000u); }
__device__ __forceinline__ float bfe(const v4u& w, int e) { const unsigned x = w[e >> 1]; return (e & 1) ? bf_hi(x) : bf_lo(x); }

__device__ __forceinline__ void p0_transpose_item(const float* W, int K, int N, bf16* WT, int row_off, LAS float* scr, int item, int lane) {
    const int nblk = N / 32, kb = item / nblk, nb = item % nblk, k0 = 64 * kb, n0 = 32 * nb;
#pragma unroll 8
    for (int i = 0; i < 32; ++i) { const int kk = 2 * i + (lane >> 5); scr[kk * 33 + (lane & 31)] = W[(size_t)(k0 + kk) * N + n0 + (lane & 31)]; }
    LDS_WAIT(); asm volatile("" ::: "memory");
    const int c = lane & 7;
#pragma unroll
    for (int j = 0; j < 4; ++j) { const int n = (lane >> 3) + 8 * j; const LAS float* s = scr + (8 * c) * 33 + n;
        v4u o; o.x = pk2(s[0 * 33], s[1 * 33]); o.y = pk2(s[2 * 33], s[3 * 33]); o.z = pk2(s[4 * 33], s[5 * 33]); o.w = pk2(s[6 * 33], s[7 * 33]);
        *(GAS v4u*)(WT + (size_t)(row_off + n0 + n) * K + k0 + 8 * c) = o; }
    LDS_WAIT(); asm volatile("" ::: "memory");
}

__device__ __forceinline__ void rope_cs(float posf, int i, float& cs, float& sn) {
    const float inv = exp2f(-(float)i * (13.287712379549449f / 64.0f));
    const float ang = posf * inv;
    const float n = rintf(ang * 0.15915494309189535f);
    float r = fmaf(-n, 6.2831854820251465f, ang);
    r = fmaf(-n, -1.7484556e-7f, r);
    cs = __cosf(r); sn = __sinf(r);
}

struct Args { const void* in[18]; float* out; unsigned char* ws; };

__global__ void __launch_bounds__(NWAVES * 64, 2) fwd_megakernel(Args args) {
    extern __shared__ __attribute__((aligned(16))) unsigned char lds_raw[];
    LAS unsigned char* lds = (LAS unsigned char*)lds_raw;
    const int tid = threadIdx.x, lane = tid & 63, wave = __builtin_amdgcn_readfirstlane(tid >> 6);
    const int G = gridDim.x, bid = blockIdx.x;
    const int gw = bid * NWAVES + wave, NGW = G * NWAVES;
    unsigned char* ws = args.ws;
    const float* x = (const float*)args.in[0];
    const float* cvec = (const float*)args.in[1];
    const int* positions = (const int*)args.in[2];
    const float* ada_w = (const float*)args.in[3];
    const float* ada_b = (const float*)args.in[4];
    const float* mix_pre_g = (const float*)args.in[5];
    const float* mix_post_g = (const float*)args.in[6];
    const float* ffn_pre_g = (const float*)args.in[7];
    const float* ffn_post_g = (const float*)args.in[8];
    const float* w_in = (const float*)args.in[9];
    const float* b_gate = (const float*)args.in[10];
    const float* pool_w = (const float*)args.in[11];
    const float* pool_scale = (const float*)args.in[12];
    const float* w_bp = (const float*)args.in[13];
    const float* w_br = (const float*)args.in[14];
    const float* w_out = (const float*)args.in[15];
    const float* w_ff1 = (const float*)args.in[16];
    const float* w_ff2 = (const float*)args.in[17];
    float* out = args.out;
    float* MOD = (float*)(ws + WS_MOD);
    bf16* WIN_t = (bf16*)(ws + WS_WIN); bf16* WPR_t = (bf16*)(ws + WS_WPR); bf16* WOUT_t = (bf16*)(ws + WS_WOUT); bf16* W1_t = (bf16*)(ws + WS_W1); bf16* W2_t = (bf16*)(ws + WS_W2);
    bf16* XN = (bf16*)(ws + WS_XN); bf16* KV = XN; bf16* MG = XN;
    bf16* POOLED = (bf16*)(ws + WS_PR); bf16* RET = POOLED + (size_t)M * 512; bf16* Y = POOLED;
    bf16* PROJ = (bf16*)(ws + WS_PROJ); bf16* HB = PROJ;

    for (int u = tid; u < (LDS_BYTES - 131072) / 4; u += NWAVES * 64) ((LAS unsigned*)(lds + 131072))[u] = 0u;
    __syncthreads();
    XcdBarrier bar = xcd_barrier_post((unsigned*)ws + CW_BAR, (volatile LAS unsigned*)(lds + MISC_OFF) + 8);

    {
        LAS float* scs = (LAS float*)lds;
        LAS float* red = (LAS float*)(lds + 32768);
        if (bid < 96) { for (int i = tid; i < BATCH * D; i += 512) { const float v = cvec[i]; scs[i] = v / (1.0f + __expf(-v)); } }
        __syncthreads();
        for (int it = bid; it < 96; it += G) {
            const int j = it * 64 + lane; float a8[8];
#pragma unroll
            for (int b = 0; b < 8; ++b) a8[b] = 0.f;
            const int k0 = wave * 128;
#pragma unroll 4
            for (int k = k0; k < k0 + 128; ++k) { const float a = ada_w[(size_t)k * NMOD + j];
#pragma unroll
                for (int b = 0; b < 8; ++b) a8[b] += scs[b * D + k] * a; }
#pragma unroll
            for (int b = 0; b < 8; ++b) red[(wave * 8 + b) * 64 + lane] = a8[b];
            __syncthreads();
            { float s = ada_b[j];
#pragma unroll
              for (int w = 0; w < 8; ++w) s += red[(w * 8 + wave) * 64 + lane];
              MOD[wave * NMOD + j] = s; }
            __syncthreads();
        }
        { int start = bid - 96; if (start < 0) start += G;
          for (int it = start; it < 128; it += G) {
            const int g = it >> 5, r = it & 31, c0 = (r >> 1) * 8, n = (r & 1) * 512 + tid; float a8[8];
#pragma unroll
            for (int ci = 0; ci < 8; ++ci) a8[ci] = 0.f;
            for (int d = 0; d < 128; ++d) { const float w = w_bp[(size_t)(g * 128 + d) * D + n] * pool_scale[g * 128 + d];
#pragma unroll
                for (int ci = 0; ci < 8; ++ci) a8[ci] += pool_w[(g * 128 + c0 + ci) * 128 + d] * w; }
            v4u o; o.x = pk2(a8[0], a8[1]); o.y = pk2(a8[2], a8[3]); o.z = pk2(a8[4], a8[5]); o.w = pk2(a8[6], a8[7]);
            *(GAS v4u*)(WPR_t + (size_t)n * 512 + g * 128 + c0) = o;
          } }
        __syncthreads();
        LAS float* scr = (LAS float*)(lds + wave * 16384);
        constexpr int I_IN = (D / 64) * (INW / 32), I_BR = (512 / 64) * (D / 32), I_O = (D / 64) * (D / 32), I_1 = (D / 64) * (FF / 32), I_2 = (FF / 64) * (D / 32);
        constexpr int NITEMS = I_IN + I_BR + I_O + I_1 + I_2;
        for (int it = gw; it < NITEMS; it += NGW) {
            int r = it;
            if (r < I_IN) { p0_transpose_item(w_in, D, INW, WIN_t, 0, scr, r, lane); continue; } r -= I_IN;
            if (r < I_BR) { p0_transpose_item(w_br, 512, D, WPR_t, 1024, scr, r, lane); continue; } r -= I_BR;
            if (r < I_O) { p0_transpose_item(w_out, D, D, WOUT_t, 0, scr, r, lane); continue; } r -= I_O;
            if (r < I_1) { p0_transpose_item(w_ff1, D, FF, W1_t, 0, scr, r, lane); continue; } r -= I_1;
            p0_transpose_item(w_ff2, FF, D, W2_t, 0, scr, r, lane);
        }
    }
    xcd_barrier(bar);

    for (int m = gw; m < M; m += NGW) {
        const int b = m >> 11;
        const GAS f32x4* xr = (const GAS f32x4*)(x + (size_t)m * D) + lane;
        f32x4 v[4]; float ss = 0.f;
#pragma unroll
        for (int j = 0; j < 4; ++j) { v[j] = xr[64 * j]; ss += (v[j].x * v[j].x + v[j].y * v[j].y) + (v[j].z * v[j].z + v[j].w * v[j].w); }
        const float rstd = 1.0f / sqrtf(wave_sum(ss) * (1.0f / D) + EPS);
        GAS unsigned long long* o8 = (GAS unsigned long long*)(XN + (size_t)m * D) + lane;
#pragma unroll
        for (int j = 0; j < 4; ++j) { const int col = 4 * (lane + 64 * j);
            const f32x4 g4 = *(const f32x4*)(mix_pre_g + col), sc4 = *(const f32x4*)(MOD + b * NMOD + 1 * D + col), sh4 = *(const f32x4*)(MOD + b * NMOD + 0 * D + col);
            const f32x4 h = v[j] * rstd * g4 * (sc4 + 1.0f) + sh4;
            o8[64 * j] = (unsigned long long)pk2(h.x, h.y) | ((unsigned long long)pk2(h.z, h.w) << 32); }
    }
    xcd_barrier(bar);

    {
        pg8::Gemm g{XN, XN, WIN_t, M, INW, D, 1 << 30}; pg8::StaticOrder S; S.init(M, INW, G, bid);
        pg8::Epi<pg8::EP_PROJ> E{PROJ, INW, b_gate, nullptr};
        pg8::gemm_phase<pg8::Epi<pg8::EP_PROJ>, pg8::StaticOrder, true, true>(lds, g, S, E);
    }
    xcd_barrier(bar);

    {
        LAS bf16* kT = (LAS bf16*)lds;
        LAS bf16* vT = (LAS bf16*)(lds + 18432);
        const int fr = lane & 15, fq = lane >> 4;
        for (int un = bid; un < 1024; un += G) {
            const int b = un >> 7, n = (un >> 2) & 31, h = un & 3;
            const float lg = log2f(1.0f - exp2f(-5.0f - (float)h));
            { const int j = tid >> 3, sub = tid & 7; const int row = b * SEQ + n * 64 + j;
              const bf16* kp = PROJ + (size_t)row * INW + C_K + h * 128 + sub * 8;
              const v4u k1 = *(const GAS v4u*)kp, k2 = *(const GAS v4u*)(kp + 64);
              const bf16* vp = PROJ + (size_t)row * INW + C_V + h * 128 + sub * 8;
              const v4u v1 = *(const GAS v4u*)vp, v2 = *(const GAS v4u*)(vp + 64);
              const float posf = (float)positions[row];
              const float dec = exp2f((float)(63 - j) * lg);
#pragma unroll
              for (int e = 0; e < 8; ++e) { const int i = sub * 8 + e; float cs, sn; rope_cs(posf, i, cs, sn);
                  const float x1 = bfe(k1, e), x2 = bfe(k2, e);
                  kT[i * 72 + j] = (bf16)f2bf((x1 * cs - x2 * sn) * dec); kT[(i + 64) * 72 + j] = (bf16)f2bf((x2 * cs + x1 * sn) * dec);
                  vT[i * 72 + j] = (bf16)(v1[e >> 1] >> ((e & 1) * 16)); vT[(i + 64) * 72 + j] = (bf16)(v2[e >> 1] >> ((e & 1) * 16)); }
            }
            __syncthreads();
            { const int d0 = wave * 16; bf16x8 af[2]; f32x4 acc[8];
#pragma unroll
              for (int ks = 0; ks < 2; ++ks) af[ks] = *(const LAS bf16x8*)(kT + (d0 + fr) * 72 + 8 * fq + 32 * ks);
#pragma unroll
              for (int et = 0; et < 8; ++et) { acc[et] = (f32x4){0.f, 0.f, 0.f, 0.f};
#pragma unroll
                  for (int ks = 0; ks < 2; ++ks) { const bf16x8 bfv = *(const LAS bf16x8*)(vT + (et * 16 + fr) * 72 + 8 * fq + 32 * ks);
                      acc[et] = __builtin_amdgcn_mfma_f32_16x16x32_bf16(af[ks], bfv, acc[et], 0, 0, 0); } }
              bf16* kvp = KV + ((size_t)((b * 4 + h) * 32 + n)) * 16384;
#pragma unroll
              for (int et = 0; et < 8; ++et)
                  *(GAS unsigned long long*)(kvp + (et * 16 + fr) * 128 + d0 + 4 * fq) = (unsigned long long)pk2(acc[et][0], acc[et][1]) | ((unsigned long long)pk2(acc[et][2], acc[et][3]) << 32);
            }
            __syncthreads();
        }
        for (int m0 = gw * 8; m0 < M; m0 += NGW * 8) {
            for (int i = 0; i < 8; ++i) { const int m = m0 + i, t = m & (SEQ - 1); const int w = 2 << (lane >> 4);
                const bf16* base = PROJ + (size_t)m * INW + C_U + lane * 8;
                const v4u cur = *(const GAS v4u*)base; float s[8];
#pragma unroll
                for (int e = 0; e < 8; ++e) s[e] = bfe(cur, e);
                const int cnt = (t + 1) < w ? (t + 1) : w;
                for (int q = 1; q < cnt; ++q) { const v4u pv = *(const GAS v4u*)(base - (size_t)q * INW);
#pragma unroll
                    for (int e = 0; e < 8; ++e) s[e] += bfe(pv, e); }
                const float ic = 1.0f / (float)cnt; v4u o;
                o.x = pk2(s[0] * ic - bfe(cur, 0), s[1] * ic - bfe(cur, 1)); o.y = pk2(s[2] * ic - bfe(cur, 2), s[3] * ic - bfe(cur, 3));
                o.z = pk2(s[4] * ic - bfe(cur, 4), s[5] * ic - bfe(cur, 5)); o.w = pk2(s[6] * ic - bfe(cur, 6), s[7] * ic - bfe(cur, 7));
                *(GAS v4u*)(POOLED + (size_t)m * 512 + lane * 8) = o; }
        }
    }
    xcd_barrier(bar);

    for (int gid = bid * 512 + tid; gid < 32 * 4096; gid += G * 512) {
        const int bh = gid >> 12, e4 = gid & 4095, h = bh & 3;
        const float cd = exp2f(64.0f * log2f(1.0f - exp2f(-5.0f - (float)h)));
        GAS unsigned long long* p = (GAS unsigned long long*)(KV + (size_t)bh * 32 * 16384 + e4 * 4);
        float s0 = 0.f, s1 = 0.f, s2 = 0.f, s3 = 0.f;
        for (int n0 = 0; n0 < 32; n0 += 8) { unsigned long long kvv[8];
#pragma unroll
            for (int q = 0; q < 8; ++q) kvv[q] = p[(size_t)(n0 + q) * 4096];
#pragma unroll
            for (int q = 0; q < 8; ++q) { p[(size_t)(n0 + q) * 4096] = (unsigned long long)pk2(s0, s1) | ((unsigned long long)pk2(s2, s3) << 32);
                const unsigned lo = (unsigned)kvv[q], hi = (unsigned)(kvv[q] >> 32);
                s0 = s0 * cd + bf_lo(lo); s1 = s1 * cd + bf_hi(lo); s2 = s2 * cd + bf_lo(hi); s3 = s3 * cd + bf_hi(hi); } }
    }
    xcd_barrier(bar);

    {
        LAS bf16* qs = (LAS bf16*)lds;
        LAS bf16* ksm = (LAS bf16*)(lds + 17408);
        LAS bf16* vT = (LAS bf16*)(lds + 34816);
        LAS bf16* Ps = (LAS bf16*)(lds + 53248);
        LAS float* Of = (LAS float*)(lds + 62464);
        const int fr = lane & 15, fq = lane >> 4;
        for (int un = bid; un < 1024; un += G) {
            const int b = un >> 7, n = (un >> 2) & 31, h = un & 3;
            const float lg = log2f(1.0f - exp2f(-5.0f - (float)h));
            const bf16* stp = KV + ((size_t)((b * 4 + h) * 32 + n)) * 16384;
            v4u st[4];
#pragma unroll
            for (int ks = 0; ks < 4; ++ks) st[ks] = *(const GAS v4u*)(stp + (wave * 16 + fr) * 128 + 8 * fq + 32 * ks);
            { const int j = tid >> 3, sub = tid & 7; const int row = b * SEQ + n * 64 + j;
              const bf16* qp = PROJ + (size_t)row * INW + C_Q + h * 128 + sub * 8;
              const v4u q1 = *(const GAS v4u*)qp, q2 = *(const GAS v4u*)(qp + 64);
              const bf16* kp = PROJ + (size_t)row * INW + C_K + h * 128 + sub * 8;
              const v4u k1 = *(const GAS v4u*)kp, k2 = *(const GAS v4u*)(kp + 64);
              const bf16* vp = PROJ + (size_t)row * INW + C_V + h * 128 + sub * 8;
              const v4u v1 = *(const GAS v4u*)vp, v2 = *(const GAS v4u*)(vp + 64);
              const float posf = (float)positions[row];
              float qa[8], qb[8], ka[8], kb[8];
#pragma unroll
              for (int e = 0; e < 8; ++e) { const int i = sub * 8 + e; float cs, sn; rope_cs(posf, i, cs, sn);
                  const float x1 = bfe(q1, e), x2 = bfe(q2, e), y1 = bfe(k1, e), y2 = bfe(k2, e);
                  qa[e] = (x1 * cs - x2 * sn) * 0.08838834764831845f; qb[e] = (x2 * cs + x1 * sn) * 0.08838834764831845f;
                  ka[e] = y1 * cs - y2 * sn; kb[e] = y2 * cs + y1 * sn;
                  vT[i * 72 + j] = (bf16)(v1[e >> 1] >> ((e & 1) * 16)); vT[(i + 64) * 72 + j] = (bf16)(v2[e >> 1] >> ((e & 1) * 16)); }
              v4u o;
              o.x = pk2(qa[0], qa[1]); o.y = pk2(qa[2], qa[3]); o.z = pk2(qa[4], qa[5]); o.w = pk2(qa[6], qa[7]); *(LAS v4u*)(qs + j * 136 + sub * 8) = o;
              o.x = pk2(qb[0], qb[1]); o.y = pk2(qb[2], qb[3]); o.z = pk2(qb[4], qb[5]); o.w = pk2(qb[6], qb[7]); *(LAS v4u*)(qs + j * 136 + 64 + sub * 8) = o;
              o.x = pk2(ka[0], ka[1]); o.y = pk2(ka[2], ka[3]); o.z = pk2(ka[4], ka[5]); o.w = pk2(ka[6], ka[7]); *(LAS v4u*)(ksm + j * 136 + sub * 8) = o;
              o.x = pk2(kb[0], kb[1]); o.y = pk2(kb[2], kb[3]); o.z = pk2(kb[4], kb[5]); o.w = pk2(kb[6], kb[7]); *(LAS v4u*)(ksm + j * 136 + 64 + sub * 8) = o;
            }
            __syncthreads();
            {
              const int it = wave >> 1; bf16x8 qf[4];
#pragma unroll
              for (int ks = 0; ks < 4; ++ks) qf[ks] = *(const LAS bf16x8*)(qs + (it * 16 + fr) * 136 + 8 * fq + 32 * ks);
#pragma unroll
              for (int jj = 0; jj < 2; ++jj) { const int jt = (wave & 1) * 2 + jj; f32x4 a = (f32x4){0.f, 0.f, 0.f, 0.f};
#pragma unroll
                  for (int ks = 0; ks < 4; ++ks) { const bf16x8 kf = *(const LAS bf16x8*)(ksm + (jt * 16 + fr) * 136 + 8 * fq + 32 * ks);
                      a = __builtin_amdgcn_mfma_f32_16x16x32_bf16(kf, qf[ks], a, 0, 0, 0); }
                  const int i = it * 16 + fr; float p[4];
#pragma unroll
                  for (int r = 0; r < 4; ++r) { const int j = jt * 16 + 4 * fq + r; p[r] = a[r] * exp2f(lg * fabsf((float)(i - j))); }
                  *(LAS unsigned long long*)(Ps + i * 72 + jt * 16 + 4 * fq) = (unsigned long long)pk2(p[0], p[1]) | ((unsigned long long)pk2(p[2], p[3]) << 32); }
            }
            __syncthreads();
            { f32x4 aI[4], aX[4];
#pragma unroll
              for (int it = 0; it < 4; ++it) { aI[it] = (f32x4){0.f, 0.f, 0.f, 0.f}; aX[it] = (f32x4){0.f, 0.f, 0.f, 0.f}; }
#pragma unroll
              for (int ks = 0; ks < 2; ++ks) { const bf16x8 vf = *(const LAS bf16x8*)(vT + (wave * 16 + fr) * 72 + 8 * fq + 32 * ks);
#pragma unroll
                  for (int it = 0; it < 4; ++it) { const bf16x8 pf = *(const LAS bf16x8*)(Ps + (it * 16 + fr) * 72 + 8 * fq + 32 * ks);
                      aI[it] = __builtin_amdgcn_mfma_f32_16x16x32_bf16(pf, vf, aI[it], 0, 0, 0); } }
#pragma unroll
              for (int ks = 0; ks < 4; ++ks) { const bf16x8 sf = __builtin_bit_cast(bf16x8, st[ks]);
#pragma unroll
                  for (int it = 0; it < 4; ++it) { const bf16x8 qf = *(const LAS bf16x8*)(qs + (it * 16 + fr) * 136 + 8 * fq + 32 * ks);
                      aX[it] = __builtin_amdgcn_mfma_f32_16x16x32_bf16(qf, sf, aX[it], 0, 0, 0); } }
#pragma unroll
              for (int it = 0; it < 4; ++it)
#pragma unroll
                  for (int r = 0; r < 4; ++r) { const int i = it * 16 + 4 * fq + r; Of[i * 132 + wave * 16 + fr] = aI[it][r] + exp2f(lg * (float)(i + 1)) * aX[it][r]; }
            }
            __syncthreads();
            { const int i = tid >> 3, part = tid & 7, e0 = part * 16; const int row = b * SEQ + n * 64 + i;
              f32x4 o[4]; float s = 0.f;
#pragma unroll
              for (int q = 0; q < 4; ++q) { o[q] = *(const LAS f32x4*)(Of + i * 132 + e0 + 4 * q); s += (o[q].x + o[q].y) + (o[q].z + o[q].w); }
              s += __shfl_xor(s, 1); s += __shfl_xor(s, 2); s += __shfl_xor(s, 4);
              const float mu = s * (1.0f / 128.0f); float vs = 0.f;
#pragma unroll
              for (int q = 0; q < 4; ++q) { o[q] = o[q] - mu; vs += (o[q].x * o[q].x + o[q].y * o[q].y) + (o[q].z * o[q].z + o[q].w * o[q].w); }
              vs += __shfl_xor(vs, 1); vs += __shfl_xor(vs, 2); vs += __shfl_xor(vs, 4);
              const float rstd = 1.0f / sqrtf(vs * (1.0f / 128.0f) + EPS);
              const bf16* gp = PROJ + (size_t)row * INW + C_G + h * 128 + e0;
              const v4u g1 = *(const GAS v4u*)gp, g2 = *(const GAS v4u*)(gp + 8);
              v4u w1, w2;
              w1.x = pk2(o[0].x * rstd * bfe(g1, 0), o[0].y * rstd * bfe(g1, 1)); w1.y = pk2(o[0].z * rstd * bfe(g1, 2), o[0].w * rstd * bfe(g1, 3));
              w1.z = pk2(o[1].x * rstd * bfe(g1, 4), o[1].y * rstd * bfe(g1, 5)); w1.w = pk2(o[1].z * rstd * bfe(g1, 6), o[1].w * rstd * bfe(g1, 7));
              w2.x = pk2(o[2].x * rstd * bfe(g2, 0), o[2].y * rstd * bfe(g2, 1)); w2.y = pk2(o[2].z * rstd * bfe(g2, 2), o[2].w * rstd * bfe(g2, 3));
              w2.z = pk2(o[3].x * rstd * bfe(g2, 4), o[3].y * rstd * bfe(g2, 5)); w2.w = pk2(o[3].z * rstd * bfe(g2, 6), o[3].w * rstd * bfe(g2, 7));
              bf16* rp = RET + (size_t)row * 512 + h * 128 + e0;
              *(GAS v4u*)rp = w1; *(GAS v4u*)(rp + 8) = w2;
            }
        }
        __syncthreads();
    }
    xcd_barrier(bar);

    {
        pg8::Gemm g{POOLED, RET, WPR_t, M, 2048, 512, 4}; pg8::MergeOrder S; S.inner.init(M, D, G, bid);
        pg8::Epi<pg8::EP_MERGE> E{MG, D, nullptr, PROJ};
        pg8::gemm_phase<pg8::Epi<pg8::EP_MERGE>, pg8::MergeOrder, true, true>(lds, g, S, E);
    }
    xcd_barrier(bar);

    {
        pg8::Gemm g{MG, MG, WOUT_t, M, D, D, 1 << 30}; pg8::StaticOrder S; S.init(M, D, G, bid);
        pg8::Epi<pg8::EP_PLAIN> E{Y, D, nullptr, nullptr};
        pg8::gemm_phase<pg8::Epi<pg8::EP_PLAIN>, pg8::StaticOrder, true, true>(lds, g, S, E);
    }
    xcd_barrier(bar);

    for (int m = gw; m < M; m += NGW) {
        const int b = m >> 11;
        const GAS f32x4* xr = (const GAS f32x4*)(x + (size_t)m * D) + lane;
        const GAS unsigned long long* yr = (const GAS unsigned long long*)(Y + (size_t)m * D) + lane;
        f32x4 v[4], y[4]; float ss = 0.f;
#pragma unroll
        for (int j = 0; j < 4; ++j) { v[j] = xr[64 * j]; const unsigned long long w = yr[64 * j]; const unsigned lo = (unsigned)w, hi = (unsigned)(w >> 32);
            y[j] = (f32x4){bf_lo(lo), bf_hi(lo), bf_lo(hi), bf_hi(hi)}; ss += (y[j].x * y[j].x + y[j].y * y[j].y) + (y[j].z * y[j].z + y[j].w * y[j].w); }
        const float rstd = 1.0f / sqrtf(wave_sum(ss) * (1.0f / D) + EPS);
        float s1 = 0.f;
        GAS f32x4* orow = (GAS f32x4*)(out + (size_t)m * D) + lane;
#pragma unroll
        for (int j = 0; j < 4; ++j) { const int col = 4 * (lane + 64 * j);
            const f32x4 g4 = *(const f32x4*)(mix_post_g + col), gt4 = *(const f32x4*)(MOD + b * NMOD + 2 * D + col);
            v[j] = v[j] + gt4 * (y[j] * rstd * g4); orow[64 * j] = v[j];
            s1 += (v[j].x * v[j].x + v[j].y * v[j].y) + (v[j].z * v[j].z + v[j].w * v[j].w); }
        const float rstd1 = 1.0f / sqrtf(wave_sum(s1) * (1.0f / D) + EPS);
        GAS unsigned long long* o8 = (GAS unsigned long long*)(XN + (size_t)m * D) + lane;
#pragma unroll
        for (int j = 0; j < 4; ++j) { const int col = 4 * (lane + 64 * j);
            const f32x4 g4 = *(const f32x4*)(ffn_pre_g + col), sc4 = *(const f32x4*)(MOD + b * NMOD + 4 * D + col), sh4 = *(const f32x4*)(MOD + b * NMOD + 3 * D + col);
            const f32x4 hh = v[j] * rstd1 * g4 * (sc4 + 1.0f) + sh4;
            o8[64 * j] = (unsigned long long)pk2(hh.x, hh.y) | ((unsigned long long)pk2(hh.z, hh.w) << 32); }
    }
    xcd_barrier(bar);

    {
        pg8::Gemm g{XN, XN, W1_t, M, FF, D, 1 << 30}; pg8::StaticOrder S; S.init(M, FF, G, bid);
        pg8::Epi<pg8::EP_RELU2> E{HB, FF, nullptr, nullptr};
        pg8::gemm_phase<pg8::Epi<pg8::EP_RELU2>, pg8::StaticOrder, true, true>(lds, g, S, E);
    }
    xcd_barrier(bar);

    {
        pg8::Gemm g{HB, HB, W2_t, M, D, FF, 1 << 30}; pg8::StaticOrder S; S.init(M, D, G, bid);
        pg8::Epi<pg8::EP_PLAIN> E{Y, D, nullptr, nullptr};
        pg8::gemm_phase<pg8::Epi<pg8::EP_PLAIN>, pg8::StaticOrder, true, true>(lds, g, S, E);
    }
    xcd_barrier(bar);

    for (int m = gw; m < M; m += NGW) {
        const int b = m >> 11;
        GAS f32x4* orow = (GAS f32x4*)(out + (size_t)m * D) + lane;
        const GAS unsigned long long* yr = (const GAS unsigned long long*)(Y + (size_t)m * D) + lane;
        f32x4 v[4], y[4]; float ss = 0.f;
#pragma unroll
        for (int j = 0; j < 4; ++j) { v[j] = orow[64 * j]; const unsigned long long w = yr[64 * j]; const unsigned lo = (unsigned)w, hi = (unsigned)(w >> 32);
            y[j] = (f32x4){bf_lo(lo), bf_hi(lo), bf_lo(hi), bf_hi(hi)}; ss += (y[j].x * y[j].x + y[j].y * y[j].y) + (y[j].z * y[j].z + y[j].w * y[j].w); }
        const float rstd = 1.0f / sqrtf(wave_sum(ss) * (1.0f / D) + EPS);
#pragma unroll
        for (int j = 0; j < 4; ++j) { const int col = 4 * (lane + 64 * j);
            const f32x4 g4 = *(const f32x4*)(ffn_post_g + col), gt4 = *(const f32x4*)(MOD + b * NMOD + 5 * D + col);
            orow[64 * j] = v[j] + gt4 * (y[j] * rstd * g4); }
    }
}

extern "C" void kernel_launch(void* const* d_in, const int* in_sizes, int n_in, void* d_out, int out_size, void* d_ws, size_t ws_size, hipStream_t stream) {
    static int grid = 0;
    if (grid == 0) {
        if (n_in != 18 || in_sizes[0] != M * D || out_size != M * D || ws_size < WS_END) { fprintf(stderr, "kernel_launch: unexpected shapes (n_in %d, in0 %d, out %d, ws %zu)\n", n_in, n_in > 0 ? in_sizes[0] : -1, out_size, ws_size); grid = -1; return; }
        int dev = 0, cus = 0, per_cu = 0;
        if (hipGetDevice(&dev) != hipSuccess || hipDeviceGetAttribute(&cus, hipDeviceAttributeMultiprocessorCount, dev) != hipSuccess) { grid = -1; return; }
        if (hipFuncSetAttribute((const void*)fwd_megakernel, hipFuncAttributeMaxDynamicSharedMemorySize, LDS_BYTES) != hipSuccess) { fprintf(stderr, "kernel_launch: hipFuncSetAttribute failed\n"); grid = -1; return; }
        if (hipOccupancyMaxActiveBlocksPerMultiprocessor(&per_cu, (const void*)fwd_megakernel, NWAVES * 64, LDS_BYTES) != hipSuccess || per_cu < 1) { fprintf(stderr, "kernel_launch: occupancy query says %d blocks per CU\n", per_cu); (void)hipGetLastError(); grid = -1; return; }
        grid = cus;
    }
    if (grid < 0) return;
    if (hipMemsetAsync((char*)d_ws + WS_CTL, 0, CTL_ZERO_BYTES, stream) != hipSuccess) { fprintf(stderr, "kernel_launch: memset failed\n"); return; }
    Args a{};
    for (int i = 0; i < 18; ++i) a.in[i] = d_in[i];
    a.out = (float*)d_out; a.ws = (unsigned char*)d_ws;
    void* kargs[] = {&a};
    const hipError_t le = hipLaunchCooperativeKernel((const void*)fwd_megakernel, dim3(grid), dim3(NWAVES * 64), kargs, LDS_BYTES, stream);
    if (le != hipSuccess) fprintf(stderr, "kernel_launch: cooperative launch failed: %s (grid %d)\n", hipGetErrorName(le), grid);
}
```
